# Optimizing an MI355X kernel written in HIP

```python
import jax
import jax.numpy as jnp
from jax import lax
import numpy as np


D_MODEL = 1024
BATCH = 4
SEQ = 4096
DEPTH = 2

CHUNK = 64
Q_BLOCK = 128

N_BRANCH = 4
BRANCH_WIDTH = 512

SC_WIDTH = 512
SC_CONV_LEN = 3

CF_WIDTH = 512
CF_CONV_LEN = 31

MLA_HEADS = 8
MLA_NOPE = 64
MLA_ROPE = 32
MLA_V = 64
MLA_Q_RANK = 256
MLA_KV_RANK = 128
ROPE_THETA = 10000.0

SB_HEADS = 8
SB_HEAD_DIM = 64

D_FF = 3584
N_EXPERTS = 8
TOP_K = 2
N_DENSE = (DEPTH + 1) // 2
N_MOE = DEPTH // 2

DN_ALPHA = (2 * DEPTH) ** 0.25
DN_BETA = (8 * DEPTH) ** -0.25

LN_EPS = 1e-5
RMS_EPS = 1e-6

IN_SIZES = (
    3 * SC_WIDTH,
    2 * CF_WIDTH,
    MLA_Q_RANK,
    MLA_KV_RANK,
    MLA_ROPE,
    3 * SB_HEADS * SB_HEAD_DIM,
    N_BRANCH * D_MODEL,
)
IN_COLS = sum(IN_SIZES)

kernel_name = "hybrid_gated_conv_mla_stickbreak_moe"


def _layer_norm(x, g, b):
    xf = x.astype(jnp.float32)
    mu = jnp.mean(xf, axis=-1, keepdims=True)
    var = jnp.mean(jnp.square(xf - mu), axis=-1, keepdims=True)
    y = (xf - mu) * lax.rsqrt(var + LN_EPS)
    return (y * g.astype(jnp.float32) + b.astype(jnp.float32)).astype(x.dtype)


def _rms_norm(x, g):
    xf = x.astype(jnp.float32)
    y = xf * lax.rsqrt(jnp.mean(jnp.square(xf), axis=-1, keepdims=True) + RMS_EPS)
    return (y * g.astype(jnp.float32)).astype(x.dtype)


def _rope_tables(positions):
    half = MLA_ROPE // 2
    inv_freq = 1.0 / (ROPE_THETA ** (jnp.arange(half, dtype=jnp.float32) * (2.0 / MLA_ROPE)))
    ang = positions.astype(jnp.float32)[..., None] * inv_freq
    return jnp.cos(ang), jnp.sin(ang)


def _apply_rope(x, cos, sin):
    half = x.shape[-1] // 2
    x1, x2 = x[..., :half], x[..., half:]
    cos = cos.astype(x.dtype)
    sin = sin.astype(x.dtype)
    return jnp.concatenate([x1 * cos - x2 * sin, x1 * sin + x2 * cos], axis=-1)


def _causal_dwconv(u, w):
    n_taps = w.shape[0]
    u_pad = jnp.pad(u, ((0, 0), (n_taps - 1, 0), (0, 0)))
    return lax.conv_general_dilated(
        u_pad, w[:, None, :].astype(u.dtype), window_strides=(1,), padding='VALID',
        dimension_numbers=('NWC', 'WIO', 'NWC'), feature_group_count=u.shape[-1])


def _split_cols(proj):
    parts = []
    start = 0
    for size in IN_SIZES:
        parts.append(proj[..., start:start + size])
        start += size
    return parts


def _short_gated_conv(b_gate, c_gate, h, w_conv):
    return b_gate * _causal_dwconv(c_gate * h, w_conv)


def _conformer_conv(val, gate, w_dw, b_dw, ln_g, ln_b):
    u = val * jax.nn.sigmoid(gate)
    u = _causal_dwconv(u, w_dw) + b_dw.astype(u.dtype)
    return jax.nn.silu(_layer_norm(u, ln_g, ln_b))


def _mla_attention(c_q, c_kv, k_rope_raw, cos, sin, q_norm, w_uq, kv_norm, w_ukv):
    bsz, seq, _ = c_q.shape
    q = (_rms_norm(c_q, q_norm) @ w_uq).reshape(bsz, seq, MLA_HEADS, MLA_NOPE + MLA_ROPE)
    q_nope = q[..., :MLA_NOPE]
    q_rope = _apply_rope(q[..., MLA_NOPE:], cos[:, :, None, :], sin[:, :, None, :])
    kv = (_rms_norm(c_kv, kv_norm) @ w_ukv).reshape(bsz, seq, MLA_HEADS, MLA_NOPE + MLA_V)
    k_nope, v = kv[..., :MLA_NOPE], kv[..., MLA_NOPE:]
    k_rope = _apply_rope(k_rope_raw, cos, sin)
    scale = (MLA_NOPE + MLA_ROPE) ** -0.5
    outs = []
    for blk in range(seq // Q_BLOCK):
        q0 = blk * Q_BLOCK
        q1 = q0 + Q_BLOCK
        s = (jnp.einsum('bqhd,bkhd->bhqk', q_nope[:, q0:q1], k_nope[:, :q1])
             + jnp.einsum('bqhd,bkd->bhqk', q_rope[:, q0:q1], k_rope[:, :q1])).astype(jnp.float32) * scale
        tq = jnp.arange(q0, q1)
        tk = jnp.arange(q1)
        allowed = (tk[None, :] // CHUNK) <= (tq[:, None] // CHUNK)
        s = jnp.where(allowed, s, -jnp.inf)
        p = jax.nn.softmax(s, axis=-1).astype(v.dtype)
        outs.append(jnp.einsum('bhqk,bkhd->bqhd', p, v[:, :q1]))
    return jnp.concatenate(outs, axis=1).reshape(bsz, seq, MLA_HEADS * MLA_V)


def _stick_breaking_attention(qkv):
    bsz, seq, _ = qkv.shape
    r = qkv.reshape(bsz, seq, 3, SB_HEADS, SB_HEAD_DIM)
    q, k, v = r[:, :, 0], r[:, :, 1], r[:, :, 2]
    scale = SB_HEAD_DIM ** -0.5
    outs = []
    for blk in range(seq // Q_BLOCK):
        q0 = blk * Q_BLOCK
        q1 = q0 + Q_BLOCK
        z = jnp.einsum('bqhd,bkhd->bhqk', q[:, q0:q1], k[:, :q1]).astype(jnp.float32) * scale
        tq = jnp.arange(q0, q1)
        tk = jnp.arange(q1)
        before = tk[None, :] < tq[:, None]
        log_stay = jnp.where(before, jax.nn.log_sigmoid(-z), 0.0)
        log_pass = lax.cumsum(log_stay, axis=3, reverse=True) - log_stay
        a = jnp.where(before, jnp.exp(jax.nn.log_sigmoid(z) + log_pass), 0.0).astype(v.dtype)
        outs.append(jnp.einsum('bhqk,bkhd->bqhd', a, v[:, :q1]))
    return jnp.concatenate(outs, axis=1).reshape(bsz, seq, SB_HEADS * SB_HEAD_DIM)


def _mixer_sublayer(x, cos, sin, w_in, b_gate, sc_conv, cf_conv, cf_conv_bias, cf_ln_g, cf_ln_b,
                    mla_q_norm, mla_w_uq, mla_kv_norm, mla_w_ukv, w_branch, w_out):
    bsz, seq, d = x.shape
    proj = x @ w_in
    sc_in, cf_in, c_q, c_kv, k_rope_raw, sb_in, gate_pre = _split_cols(proj)
    sc_b, sc_c, sc_h = jnp.split(sc_in, 3, axis=-1)
    cf_val, cf_gate = jnp.split(cf_in, 2, axis=-1)
    branches = (
        _short_gated_conv(sc_b, sc_c, sc_h, sc_conv),
        _conformer_conv(cf_val, cf_gate, cf_conv, cf_conv_bias, cf_ln_g, cf_ln_b),
        _mla_attention(c_q, c_kv, k_rope_raw, cos, sin, mla_q_norm, mla_w_uq, mla_kv_norm, mla_w_ukv),
        _stick_breaking_attention(sb_in),
    )
    gates = jax.nn.sigmoid(gate_pre + b_gate).reshape(bsz, seq, N_BRANCH, d)
    merged = gates[:, :, 0] * (branches[0] @ w_branch[0])
    for n in range(1, N_BRANCH):
        merged = merged + gates[:, :, n] * (branches[n] @ w_branch[n])
    return merged @ w_out


def _swiglu(x, w_gate, w_up, w_down):
    return (jax.nn.silu(x @ w_gate) * (x @ w_up)) @ w_down


def _moe_swiglu(x, w_router, w_gate, w_up, w_down):
    bsz, seq, d = x.shape
    xf = x.reshape(bsz * seq, d)
    logits = (xf @ w_router).astype(jnp.float32)
    top_vals, top_idx = lax.top_k(logits, TOP_K)
    top_w = jax.nn.softmax(top_vals, axis=-1)
    combine = jnp.sum(jax.nn.one_hot(top_idx, N_EXPERTS, dtype=jnp.float32) * top_w[..., None], axis=1)
    out = jnp.zeros_like(xf)
    for e in range(N_EXPERTS):
        out = out + combine[:, e:e + 1].astype(xf.dtype) * _swiglu(xf, w_gate[e], w_up[e], w_down[e])
    return out.reshape(bsz, seq, d)


def setup_inputs(seed: int = 0) -> dict:
    key = jax.random.key(seed)
    ks = jax.random.split(key, 32)
    L = DEPTH
    D = D_MODEL

    def nrm(i, shape, scale):
        return jax.random.normal(ks[i], shape, jnp.float32) * scale

    x = nrm(0, (BATCH, SEQ, D), 1.0)
    offsets = jax.random.randint(ks[1], (BATCH, 1), 0, 4 * SEQ)
    positions = (offsets + jnp.arange(SEQ)[None, :]).astype(jnp.int32)
    return {
        'x': x,
        'positions': positions,
        'w_in': nrm(2, (L, D, IN_COLS), D ** -0.5),
        'b_gate': nrm(3, (L, N_BRANCH * D), 0.02),
        'sc_conv': nrm(4, (L, SC_CONV_LEN, SC_WIDTH), SC_CONV_LEN ** -0.5),
        'cf_conv': nrm(5, (L, CF_CONV_LEN, CF_WIDTH), CF_CONV_LEN ** -0.5),
        'cf_conv_bias': nrm(6, (L, CF_WIDTH), 0.02),
        'cf_ln_g': 1.0 + nrm(7, (L, CF_WIDTH), 0.02),
        'cf_ln_b': nrm(8, (L, CF_WIDTH), 0.02),
        'mla_q_norm': 1.0 + nrm(9, (L, MLA_Q_RANK), 0.02),
        'mla_w_uq': nrm(10, (L, MLA_Q_RANK, MLA_HEADS * (MLA_NOPE + MLA_ROPE)), MLA_Q_RANK ** -0.5),
        'mla_kv_norm': 1.0 + nrm(11, (L, MLA_KV_RANK), 0.02),
        'mla_w_ukv': nrm(12, (L, MLA_KV_RANK, MLA_HEADS * (MLA_NOPE + MLA_V)), MLA_KV_RANK ** -0.5),
        'w_branch': nrm(13, (L, N_BRANCH, BRANCH_WIDTH, D), BRANCH_WIDTH ** -0.5 * DN_BETA),
        'w_out': nrm(14, (L, D, D), D ** -0.5 * DN_BETA),
        'ln_mix_g': 1.0 + nrm(15, (L, D), 0.02),
        'ln_mix_b': nrm(16, (L, D), 0.02),
        'ln_ffn_g': 1.0 + nrm(17, (L, D), 0.02),
        'ln_ffn_b': nrm(18, (L, D), 0.02),
        'ffn_w_gate': nrm(19, (N_DENSE, D, D_FF), D ** -0.5),
        'ffn_w_up': nrm(20, (N_DENSE, D, D_FF), D ** -0.5),
        'ffn_w_down': nrm(21, (N_DENSE, D_FF, D), D_FF ** -0.5 * DN_BETA),
        'router_w': nrm(22, (N_MOE, D, N_EXPERTS), D ** -0.5),
        'exp_w_gate': nrm(23, (N_MOE, N_EXPERTS, D, D_FF), D ** -0.5),
        'exp_w_up': nrm(24, (N_MOE, N_EXPERTS, D, D_FF), D ** -0.5),
        'exp_w_down': nrm(25, (N_MOE, N_EXPERTS, D_FF, D), D_FF ** -0.5 * DN_BETA),
    }


def reference(x, positions, w_in, b_gate, sc_conv, cf_conv, cf_conv_bias, cf_ln_g, cf_ln_b,
              mla_q_norm, mla_w_uq, mla_kv_norm, mla_w_ukv, w_branch, w_out,
              ln_mix_g, ln_mix_b, ln_ffn_g, ln_ffn_b, ffn_w_gate, ffn_w_up, ffn_w_down,
              router_w, exp_w_gate, exp_w_up, exp_w_down):
    cos, sin = _rope_tables(positions)
    for layer in range(DEPTH):
        y = _mixer_sublayer(x, cos, sin, w_in[layer], b_gate[layer], sc_conv[layer], cf_conv[layer],
                            cf_conv_bias[layer], cf_ln_g[layer], cf_ln_b[layer], mla_q_norm[layer],
                            mla_w_uq[layer], mla_kv_norm[layer], mla_w_ukv[layer], w_branch[layer],
                            w_out[layer])
        x = _layer_norm(DN_ALPHA * x + y, ln_mix_g[layer], ln_mix_b[layer])
        if layer % 2 == 0:
            i = layer // 2
            f = _swiglu(x, ffn_w_gate[i], ffn_w_up[i], ffn_w_down[i])
        else:
            i = layer // 2
            f = _moe_swiglu(x, router_w[i], exp_w_gate[i], exp_w_up[i], exp_w_down[i])
        x = _layer_norm(DN_ALPHA * x + f, ln_ffn_g[layer], ln_ffn_b[layer])
    return x
```

```cpp
#include <hip/hip_runtime.h>
#include <cstdio>
#include <cstdint>
#include <cmath>

namespace refp {
typedef short bf16x8 __attribute__((ext_vector_type(8)));
typedef float f32x16 __attribute__((ext_vector_type(16)));
typedef float f32x4 __attribute__((ext_vector_type(4)));

constexpr int D = 1024, SEQ = 4096, NB = 4, NTOK = NB * SEQ;
constexpr int IN_COLS = 8608;
constexpr int OFF_SC = 0, OFF_CF = 1536, OFF_CQ = 2560, OFF_CKV = 2816, OFF_KR = 2944, OFF_SB = 2976, OFF_GATE = 4512;
constexpr int DFF = 3584, NEXP = 8;
constexpr float LN_EPS = 1e-5f, RMS_EPS = 1e-6f;
constexpr float DN_ALPHA = 1.41421356237309515f;

__device__ __forceinline__ unsigned short f2bf(float f) { unsigned u = __builtin_bit_cast(unsigned, f); return (unsigned short)((u + 0x7fffu + ((u >> 16) & 1u)) >> 16); }
__device__ __forceinline__ float sigmoidf_(float x) { return 1.f / (1.f + __expf(-x)); }
__device__ __forceinline__ float siluf_(float x) { return x / (1.f + __expf(-x)); }

template <int EPI>
__global__ void __launch_bounds__(256) gemm(const float* __restrict__ A, int lda, const float* __restrict__ B, int ldb, float* C, int ldc, int M, int N, int K,
                                            const float* __restrict__ aux1, int ld1, const float* __restrict__ aux2, int accum) {
    const int lane = threadIdx.x & 63, w = threadIdx.x >> 6, r = lane & 31, h = lane >> 5;
    const int m0 = blockIdx.y * 64 + 32 * (w >> 1), n0 = blockIdx.x * 64 + 32 * (w & 1);
    const int n = n0 + r; const bool nok = n < N;
    f32x16 acc; for (int i = 0; i < 16; ++i) acc[i] = 0.f;
    const float* Ap = A + (size_t)(m0 + r) * lda + 8 * h;
    const float* Bp = B + (size_t)(8 * h) * ldb + (nok ? n : 0);
    for (int k0 = 0; k0 < K; k0 += 16) {
        bf16x8 a, b;
        const f32x4 a0 = *(const f32x4*)(Ap + k0), a1 = *(const f32x4*)(Ap + k0 + 4);
        a[0] = (short)f2bf(a0[0]); a[1] = (short)f2bf(a0[1]); a[2] = (short)f2bf(a0[2]); a[3] = (short)f2bf(a0[3]);
        a[4] = (short)f2bf(a1[0]); a[5] = (short)f2bf(a1[1]); a[6] = (short)f2bf(a1[2]); a[7] = (short)f2bf(a1[3]);
#pragma unroll
        for (int j = 0; j < 8; ++j) { const float bv = nok ? Bp[(size_t)(k0 + j) * ldb] : 0.f; b[j] = (short)f2bf(bv); }
        acc = __builtin_amdgcn_mfma_f32_32x32x16_bf16(a, b, acc, 0, 0, 0);
    }
    if (!nok) return;
#pragma unroll
    for (int i = 0; i < 16; ++i) {
        const int m = m0 + (i & 3) + 8 * (i >> 2) + 4 * h;
        float* cp = C + (size_t)m * ldc + n;
        if (EPI == 0) *cp = acc[i];
        else if (EPI == 1) { const float g = sigmoidf_(aux1[(size_t)m * ld1 + n] + aux2[n]); *cp = (accum ? *cp : 0.f) + g * acc[i]; }
        else { *cp = *cp + aux1[(size_t)m * ld1] * acc[i]; }
    }
}

__global__ void rope_tables(const int* __restrict__ pos, float* cs, float* sn) {
    const int i = blockIdx.x * blockDim.x + threadIdx.x; if (i >= NTOK * 16) return;
    const int t = i >> 4, f = i & 15;
    const float inv = 1.0f / powf(10000.0f, (float)f * (2.0f / 32.0f));
    const float ang = (float)pos[t] * inv;
    const double a = (double)ang; const double k = rint(a * 0.15915494309189535); const double rr = a - k * 6.283185307179586476925;
    cs[i] = (float)cos(rr); sn[i] = (float)sin(rr);
}

__global__ void short_conv(const float* __restrict__ proj, const float* __restrict__ w  , float* br  ) {
    const int i = blockIdx.x * blockDim.x + threadIdx.x; if (i >= SEQ * 512) return;
    const int t = i >> 9, c = i & 511;
    float s = 0.f;
    for (int l = 0; l < 3; ++l) { const int tt = t - 2 + l; if (tt < 0) continue; const float* p = proj + (size_t)tt * IN_COLS + OFF_SC; s += w[l * 512 + c] * (p[512 + c] * p[1024 + c]); }
    br[(size_t)t * 2048 + c] = proj[(size_t)t * IN_COLS + OFF_SC + c] * s;
}

__global__ void __launch_bounds__(512) conformer(const float* __restrict__ proj, const float* __restrict__ w  , const float* __restrict__ bias, const float* __restrict__ lg, const float* __restrict__ lb, float* br) {
    __shared__ float red[16];
    const int t = blockIdx.x, c = threadIdx.x;
    float s = 0.f;
    for (int l = 0; l < 31; ++l) { const int tt = t - 30 + l; if (tt < 0) continue; const float* p = proj + (size_t)tt * IN_COLS + OFF_CF; s += w[l * 512 + c] * (p[c] * sigmoidf_(p[512 + c])); }
    s += bias[c];
    float v = s; for (int o = 1; o < 64; o <<= 1) v += __shfl_xor(v, o);
    if ((c & 63) == 0) red[c >> 6] = v; __syncthreads();
    float mean = 0.f; for (int i = 0; i < 8; ++i) mean += red[i]; mean *= (1.f / 512.f);
    const float d = s - mean; float q = d * d; for (int o = 1; o < 64; o <<= 1) q += __shfl_xor(q, o);
    if ((c & 63) == 0) red[8 + (c >> 6)] = q; __syncthreads();
    float var = 0.f; for (int i = 0; i < 8; ++i) var += red[8 + i]; var *= (1.f / 512.f);
    const float y = d * rsqrtf(var + LN_EPS) * lg[c] + lb[c];
    br[(size_t)t * 2048 + 512 + c] = siluf_(y);
}

__global__ void rms_rows(const float* __restrict__ proj, int off, int W, const float* __restrict__ g, float* out) {
    const int t = blockIdx.x * 4 + (threadIdx.x >> 6), lane = threadIdx.x & 63;
    const float* p = proj + (size_t)t * IN_COLS + off;
    float s = 0.f; for (int c = lane; c < W; c += 64) s += p[c] * p[c];
    for (int o = 1; o < 64; o <<= 1) s += __shfl_xor(s, o);
    const float r = rsqrtf(s / (float)W + RMS_EPS);
    for (int c = lane; c < W; c += 64) out[(size_t)t * W + c] = p[c] * r * g[c];
}

__global__ void rope_apply(float* q, const float* __restrict__ proj, float* kr, const float* __restrict__ cs, const float* __restrict__ sn) {
    const int i = blockIdx.x * blockDim.x + threadIdx.x; if (i >= SEQ * 9 * 16) return;
    const int t = i / 144, rem = i % 144, hh = rem >> 4, f = rem & 15;
    const float c = cs[t * 16 + f], s = sn[t * 16 + f];
    if (hh < 8) { float* p = q + (size_t)t * 768 + hh * 96 + 64; const float x1 = p[f], x2 = p[16 + f]; p[f] = x1 * c - x2 * s; p[16 + f] = x1 * s + x2 * c; }
    else { const float* p = proj + (size_t)t * IN_COLS + OFF_KR; const float x1 = p[f], x2 = p[16 + f]; kr[t * 32 + f] = x1 * c - x2 * s; kr[t * 32 + 16 + f] = x1 * s + x2 * c; }
}

__global__ void __launch_bounds__(256) mla_attn(const float* __restrict__ q  , const float* __restrict__ kv  , const float* __restrict__ kr  , float* br) {
    __shared__ float Qs[16][97], Ks[64][97], Vs[64][65], Ps[16][65];
    const int t0 = blockIdx.x * 16, hh = blockIdx.y, tid = threadIdx.x, qi = tid >> 4, kl = tid & 15;
    for (int i = tid; i < 16 * 96; i += 256) { const int a = i / 96, d = i % 96; Qs[a][d] = q[(size_t)(t0 + a) * 768 + hh * 96 + d]; }
    float m = -INFINITY, l = 0.f, o[4] = {0.f, 0.f, 0.f, 0.f};
    const float scale = 0.10206207261596575f;
    const int nt = t0 / 64 + 1;
    for (int kt = 0; kt < nt; ++kt) {
        __syncthreads();
        for (int i = tid; i < 64 * 96; i += 256) { const int a = i / 96, d = i % 96; Ks[a][d] = d < 64 ? kv[(size_t)(kt * 64 + a) * 1024 + hh * 128 + d] : kr[(size_t)(kt * 64 + a) * 32 + d - 64]; }
        for (int i = tid; i < 64 * 64; i += 256) { const int a = i >> 6, d = i & 63; Vs[a][d] = kv[(size_t)(kt * 64 + a) * 1024 + hh * 128 + 64 + d]; }
        __syncthreads();
        float s[4]; float mx = -INFINITY;
        for (int j = 0; j < 4; ++j) { const int key = kl + 16 * j; float a = 0.f; for (int d = 0; d < 96; ++d) a += Qs[qi][d] * Ks[key][d]; s[j] = a * scale; mx = fmaxf(mx, s[j]); }
        for (int o2 = 1; o2 < 16; o2 <<= 1) mx = fmaxf(mx, __shfl_xor(mx, o2));
        const float mn = fmaxf(m, mx), sc = __expf(m - mn);
        float ps = 0.f; for (int j = 0; j < 4; ++j) { const float p = __expf(s[j] - mn); Ps[qi][kl + 16 * j] = p; ps += p; }
        for (int o2 = 1; o2 < 16; o2 <<= 1) ps += __shfl_xor(ps, o2);
        l = l * sc + ps; m = mn;
        __syncthreads();
        for (int j = 0; j < 4; ++j) o[j] *= sc;
        for (int key = 0; key < 64; ++key) { const float p = Ps[qi][key]; for (int j = 0; j < 4; ++j) o[j] += p * Vs[key][kl * 4 + j]; }
    }
    for (int j = 0; j < 4; ++j) br[(size_t)(t0 + qi) * 2048 + 1024 + hh * 64 + kl * 4 + j] = o[j] / l;
}

__global__ void __launch_bounds__(256) sb_attn(const float* __restrict__ proj, float* br) {
    __shared__ float Qs[16][65], Ks[64][65], Vs[64][65], Zs[16][65], As[16][65];
    const int t0 = blockIdx.x * 16, hh = blockIdx.y, tid = threadIdx.x, qi = tid >> 4, kl = tid & 15;
    for (int i = tid; i < 16 * 64; i += 256) { const int a = i >> 6, d = i & 63; Qs[a][d] = proj[(size_t)(t0 + a) * IN_COLS + OFF_SB + hh * 64 + d]; }
    float o[4] = {0.f, 0.f, 0.f, 0.f};
    float Crun = 0.f;
    for (int kt = t0 / 64; kt >= 0; --kt) {
        __syncthreads();
        for (int i = tid; i < 64 * 64; i += 256) { const int a = i >> 6, d = i & 63; const float* p = proj + (size_t)(kt * 64 + a) * IN_COLS + OFF_SB + hh * 64 + d; Ks[a][d] = p[512]; Vs[a][d] = p[1024]; }
        __syncthreads();
        for (int j = 0; j < 4; ++j) { const int key = kl + 16 * j; float a = 0.f; for (int d = 0; d < 64; ++d) a += Qs[qi][d] * Ks[key][d]; Zs[qi][key] = a * 0.125f; }
        __syncthreads();
        if (tid < 16) {
            const int t = t0 + tid;
            for (int key = 63; key >= 0; --key) {
                const int j = kt * 64 + key; float a = 0.f;
                if (j < t) { const float z = Zs[tid][key]; const float sp = fmaxf(z, 0.f) + log1pf(__expf(-fabsf(z))); Crun += sp; a = __expf(z - Crun); }
                As[tid][key] = a;
            }
        }
        __syncthreads();
        for (int key = 0; key < 64; ++key) { const float p = As[qi][key]; for (int j = 0; j < 4; ++j) o[j] += p * Vs[key][kl * 4 + j]; }
    }
    for (int j = 0; j < 4; ++j) br[(size_t)(t0 + qi) * 2048 + 1536 + hh * 64 + kl * 4 + j] = o[j];
}

__global__ void __launch_bounds__(256) ln_res(const float* __restrict__ x, const float* __restrict__ y, const float* __restrict__ g, const float* __restrict__ b, float* out) {
    __shared__ float red[8];
    const int t = blockIdx.x, tid = threadIdx.x;
    float v[4]; float s = 0.f;
    for (int j = 0; j < 4; ++j) { const int c = tid + 256 * j; v[j] = DN_ALPHA * x[(size_t)t * D + c] + y[(size_t)t * D + c]; s += v[j]; }
    for (int o = 1; o < 64; o <<= 1) s += __shfl_xor(s, o);
    if ((tid & 63) == 0) red[tid >> 6] = s; __syncthreads();
    const float mean = (red[0] + red[1] + red[2] + red[3]) * (1.f / D);
    float q = 0.f; for (int j = 0; j < 4; ++j) { v[j] -= mean; q += v[j] * v[j]; }
    for (int o = 1; o < 64; o <<= 1) q += __shfl_xor(q, o);
    if ((tid & 63) == 0) red[4 + (tid >> 6)] = q; __syncthreads();
    const float rstd = rsqrtf((red[4] + red[5] + red[6] + red[7]) * (1.f / D) + LN_EPS);
    for (int j = 0; j < 4; ++j) { const int c = tid + 256 * j; out[(size_t)t * D + c] = v[j] * rstd * g[c] + b[c]; }
}

__global__ void swiglu_ew(float* g, const float* __restrict__ u, size_t n) { const size_t i = (size_t)blockIdx.x * blockDim.x + threadIdx.x; if (i < n) g[i] = siluf_(g[i]) * u[i]; }
__global__ void zero_f32(float* p, size_t n) { const size_t i = (size_t)blockIdx.x * blockDim.x + threadIdx.x; if (i < n) p[i] = 0.f; }

__global__ void __launch_bounds__(256) router(const float* __restrict__ x, const float* __restrict__ rw  , float* comb) {
    const int t = blockIdx.x * 4 + (threadIdx.x >> 6), lane = threadIdx.x & 63;
    float lg[8]; for (int e = 0; e < 8; ++e) lg[e] = 0.f;
    for (int k = lane; k < D; k += 64) { const float xv = x[(size_t)t * D + k]; for (int e = 0; e < 8; ++e) lg[e] += xv * rw[k * 8 + e]; }
    for (int e = 0; e < 8; ++e) for (int o = 1; o < 64; o <<= 1) lg[e] += __shfl_xor(lg[e], o);
    int i1 = 0; for (int e = 1; e < 8; ++e) if (lg[e] > lg[i1]) i1 = e;
    int i2 = (i1 == 0) ? 1 : 0; for (int e = 0; e < 8; ++e) if (e != i1 && lg[e] > lg[i2]) i2 = e;
    const float e2 = __expf(lg[i2] - lg[i1]); const float w1 = 1.f / (1.f + e2), w2 = e2 / (1.f + e2);
    if (lane < 8) comb[(size_t)t * 8 + lane] = (lane == i1) ? w1 : (lane == i2) ? w2 : 0.f;
}

struct Inputs {
    const float* x; const int* pos; const float *w_in, *b_gate, *sc_conv, *cf_conv, *cf_bias, *cf_ln_g, *cf_ln_b, *q_norm, *w_uq, *kv_norm, *w_ukv, *w_branch, *w_out,
        *ln_mix_g, *ln_mix_b, *ln_ffn_g, *ln_ffn_b, *ffn_wg, *ffn_wu, *ffn_wd, *router_w, *exp_wg, *exp_wu, *exp_wd;
};
constexpr size_t R_COS = 0, R_SIN = R_COS + (size_t)NTOK * 16, R_XA = R_SIN + (size_t)NTOK * 16, R_PROJ = R_XA + (size_t)NTOK * D,
    R_BR = R_PROJ + (size_t)SEQ * IN_COLS, R_CQN = R_BR + (size_t)SEQ * 2048, R_CKVN = R_CQN + (size_t)SEQ * 256, R_Q = R_CKVN + (size_t)SEQ * 128,
    R_KV = R_Q + (size_t)SEQ * 768, R_KR = R_KV + (size_t)SEQ * 1024, R_MERGED = R_KR + (size_t)SEQ * 32, R_Y = R_MERGED + (size_t)SEQ * D,
    R_X1 = R_Y + (size_t)SEQ * D, R_F = R_X1 + (size_t)SEQ * D, R_COMB = R_F + (size_t)SEQ * D, R_END = R_COMB + (size_t)SEQ * 8;

template <int EPI>
static void launch_gemm(hipStream_t st, const float* A, int lda, const float* B, int ldb, float* C, int ldc, int M, int N, int K, const float* a1 = nullptr, int ld1 = 0, const float* a2 = nullptr, int accum = 0) {
    hipLaunchKernelGGL(gemm<EPI>, dim3((N + 63) / 64, M / 64), dim3(256), 0, st, A, lda, B, ldb, C, ldc, M, N, K, a1, ld1, a2, accum);
}

static void run(const Inputs& I, float* ws, float* out, hipStream_t st, const int* batch_order = nullptr, int nbatch = NB) {
    float* cs = ws + R_COS; float* sn = ws + R_SIN; float* XA = ws + R_XA; float* proj = ws + R_PROJ; float* br = ws + R_BR;
    float* cqn = ws + R_CQN; float* ckvn = ws + R_CKVN; float* q = ws + R_Q; float* kv = ws + R_KV; float* kr = ws + R_KR;
    float* merged = ws + R_MERGED; float* y = ws + R_Y; float* x1 = ws + R_X1; float* f = ws + R_F; float* comb = ws + R_COMB;
    hipLaunchKernelGGL(rope_tables, dim3(NTOK * 16 / 256), dim3(256), 0, st, I.pos, cs, sn);
    for (int layer = 0; layer < 2; ++layer) {
        const float* w_in = I.w_in + (size_t)layer * D * IN_COLS;
        for (int bi = 0; bi < nbatch; ++bi) {
            const int b = batch_order ? batch_order[bi] : bi;
            const float* xin = (layer == 0 ? I.x : XA) + (size_t)b * SEQ * D;
            float* xout = (layer == 0 ? XA : out) + (size_t)b * SEQ * D;
            launch_gemm<0>(st, xin, D, w_in, IN_COLS, proj, IN_COLS, SEQ, IN_COLS, D);
            hipLaunchKernelGGL(short_conv, dim3(SEQ * 512 / 256), dim3(256), 0, st, proj, I.sc_conv + layer * 3 * 512, br);
            hipLaunchKernelGGL(conformer, dim3(SEQ), dim3(512), 0, st, proj, I.cf_conv + layer * 31 * 512, I.cf_bias + layer * 512, I.cf_ln_g + layer * 512, I.cf_ln_b + layer * 512, br);
            hipLaunchKernelGGL(rms_rows, dim3(SEQ / 4), dim3(256), 0, st, proj, OFF_CQ, 256, I.q_norm + layer * 256, cqn);
            hipLaunchKernelGGL(rms_rows, dim3(SEQ / 4), dim3(256), 0, st, proj, OFF_CKV, 128, I.kv_norm + layer * 128, ckvn);
            launch_gemm<0>(st, cqn, 256, I.w_uq + (size_t)layer * 256 * 768, 768, q, 768, SEQ, 768, 256);
            launch_gemm<0>(st, ckvn, 128, I.w_ukv + (size_t)layer * 128 * 1024, 1024, kv, 1024, SEQ, 1024, 128);
            hipLaunchKernelGGL(rope_apply, dim3((SEQ * 144 + 255) / 256), dim3(256), 0, st, q, proj, kr, cs + (size_t)b * SEQ * 16, sn + (size_t)b * SEQ * 16);
            hipLaunchKernelGGL(mla_attn, dim3(SEQ / 16, 8), dim3(256), 0, st, q, kv, kr, br);
            hipLaunchKernelGGL(sb_attn, dim3(SEQ / 16, 8), dim3(256), 0, st, proj, br);
            for (int n = 0; n < 4; ++n)
                launch_gemm<1>(st, br + n * 512, 2048, I.w_branch + ((size_t)layer * 4 + n) * 512 * D, D, merged, D, SEQ, D, 512, proj + OFF_GATE + n * D, IN_COLS, I.b_gate + layer * 4096 + n * D, n > 0);
            launch_gemm<0>(st, merged, D, I.w_out + (size_t)layer * D * D, D, y, D, SEQ, D, D);
            hipLaunchKernelGGL(ln_res, dim3(SEQ), dim3(256), 0, st, xin, y, I.ln_mix_g + layer * D, I.ln_mix_b + layer * D, x1);
            float* g = proj; float* u = proj + (size_t)SEQ * DFF;
            const size_t nh = (size_t)SEQ * DFF;
            if (layer == 0) {
                launch_gemm<0>(st, x1, D, I.ffn_wg, DFF, g, DFF, SEQ, DFF, D);
                launch_gemm<0>(st, x1, D, I.ffn_wu, DFF, u, DFF, SEQ, DFF, D);
                hipLaunchKernelGGL(swiglu_ew, dim3((unsigned)((nh + 255) / 256)), dim3(256), 0, st, g, u, nh);
                launch_gemm<0>(st, g, DFF, I.ffn_wd, D, f, D, SEQ, D, DFF);
            } else {
                hipLaunchKernelGGL(router, dim3(SEQ / 4), dim3(256), 0, st, x1, I.router_w, comb);
                hipLaunchKernelGGL(zero_f32, dim3(SEQ * D / 256), dim3(256), 0, st, f, (size_t)SEQ * D);
                for (int e = 0; e < NEXP; ++e) {
                    launch_gemm<0>(st, x1, D, I.exp_wg + (size_t)e * D * DFF, DFF, g, DFF, SEQ, DFF, D);
                    launch_gemm<0>(st, x1, D, I.exp_wu + (size_t)e * D * DFF, DFF, u, DFF, SEQ, DFF, D);
                    hipLaunchKernelGGL(swiglu_ew, dim3((unsigned)((nh + 255) / 256)), dim3(256), 0, st, g, u, nh);
                    launch_gemm<2>(st, g, DFF, I.exp_wd + (size_t)e * DFF * D, D, f, D, SEQ, D, DFF, comb + e, 8, nullptr, 0);
                }
            }
            hipLaunchKernelGGL(ln_res, dim3(SEQ), dim3(256), 0, st, x1, f, I.ln_ffn_g + layer * D, I.ln_ffn_b + layer * D, xout);
        }
    }
}
}

extern "C" void kernel_launch(void* const* d_in, const int* in_sizes, int n_in, void* d_out, int out_size, void* d_ws, size_t ws_size, hipStream_t stream) {
    (void)in_sizes; (void)n_in; (void)out_size; (void)ws_size;
    refp::Inputs I{};
    I.x = (const float*)d_in[0]; I.pos = (const int*)d_in[1]; I.w_in = (const float*)d_in[2]; I.b_gate = (const float*)d_in[3]; I.sc_conv = (const float*)d_in[4];
    I.cf_conv = (const float*)d_in[5]; I.cf_bias = (const float*)d_in[6]; I.cf_ln_g = (const float*)d_in[7]; I.cf_ln_b = (const float*)d_in[8];
    I.q_norm = (const float*)d_in[9]; I.w_uq = (const float*)d_in[10]; I.kv_norm = (const float*)d_in[11]; I.w_ukv = (const float*)d_in[12];
    I.w_branch = (const float*)d_in[13]; I.w_out = (const float*)d_in[14]; I.ln_mix_g = (const float*)d_in[15]; I.ln_mix_b = (const float*)d_in[16];
    I.ln_ffn_g = (const float*)d_in[17]; I.ln_ffn_b = (const float*)d_in[18]; I.ffn_wg = (const float*)d_in[19]; I.ffn_wu = (const float*)d_in[20]; I.ffn_wd = (const float*)d_in[21];
    I.router_w = (const float*)d_in[22]; I.exp_wg = (const float*)d_in[23]; I.exp_wu = (const float*)d_in[24]; I.exp_wd = (const float*)d_in[25];
    refp::run(I, (float*)d_ws, (float*)d_out, stream);
}
```
